# Optimizing an MI355X kernel written in HIP

```python
import math
import jax, jax.numpy as jnp
from jax import lax
import numpy as np

D_MODEL = 1024
BATCH = 8
SEQ = 2048
DEPTH = 1

ROPE_THETA = 500000.0
Q_BLOCK = 128
NORM_EPS = 1e-6
SUBLN_EPS = 1e-5

MLA_HEADS = 4
MLA_NOPE = 128
MLA_ROPE = 64
MLA_V = 128
KV_RANK = 128
MLA_WIDTH = MLA_HEADS * MLA_V

DIFF_HEADS = 4
DIFF_QK = 64
DIFF_V = 2 * DIFF_QK
DIFF_ROPE = DIFF_QK // 4
DIFF_WIDTH = DIFF_HEADS * DIFF_V

MIX_WIDTH = MLA_WIDTH + DIFF_WIDTH

PROJ_SIZES = (
    MLA_HEADS * MLA_NOPE,
    MLA_HEADS * MLA_ROPE,
    KV_RANK,
    MLA_ROPE,
    MLA_WIDTH,
    DIFF_HEADS * 2 * DIFF_QK,
    DIFF_HEADS * 2 * DIFF_QK,
    DIFF_WIDTH,
    DIFF_WIDTH,
)
PROJ_OUT = sum(PROJ_SIZES)
PROJ_SPLITS = tuple(int(s) for s in np.cumsum(PROJ_SIZES)[:-1])

kernel_name = "hybrid_mla_diffattn_parallel_heads"


def rmsnorm(x, g, eps=NORM_EPS):
    xf = x.astype(jnp.float32)
    y = xf * lax.rsqrt(jnp.mean(xf * xf, axis=-1, keepdims=True) + eps)
    return (y * g.astype(jnp.float32)).astype(x.dtype)


def rope_tables(seq, dim):
    inv_freq = ROPE_THETA ** (-jnp.arange(0, dim, 2, dtype=jnp.float32) / dim)
    ang = jnp.arange(seq, dtype=jnp.float32)[:, None] * inv_freq[None, :]
    return jnp.cos(ang), jnp.sin(ang)


def apply_rope(x, cos, sin):
    half = cos.shape[-1]
    shp = (1, x.shape[1]) + (1,) * (x.ndim - 3) + (half,)
    c = cos.reshape(shp).astype(x.dtype)
    s = sin.reshape(shp).astype(x.dtype)
    x1 = x[..., :half]
    x2 = x[..., half:2 * half]
    rot = jnp.concatenate([x1 * c - x2 * s, x2 * c + x1 * s], axis=-1)
    return jnp.concatenate([rot, x[..., 2 * half:]], axis=-1)


def causal_attention(q, k, v, scale):
    B, S, H, Dk = q.shape
    Dv = v.shape[-1]
    nb = S // Q_BLOCK
    qb = q.reshape(B, nb, Q_BLOCK, H, Dk).transpose(1, 0, 2, 3, 4)
    kpos = jnp.arange(S)

    def one_block(args):
        qi, i = args
        s = jnp.einsum('bqhd,bkhd->bhqk', qi, k).astype(jnp.float32) * scale
        qpos = i * Q_BLOCK + jnp.arange(Q_BLOCK)
        mask = kpos[None, :] <= qpos[:, None]
        s = jnp.where(mask[None, None], s, -jnp.inf)
        p = jax.nn.softmax(s, axis=-1).astype(v.dtype)
        return jnp.einsum('bhqk,bkhd->bqhd', p, v)

    out = lax.map(one_block, (qb, jnp.arange(nb)))
    return out.transpose(1, 0, 2, 3, 4).reshape(B, S, H, Dv)


def setup_inputs(seed: int = 0) -> dict:
    key = jax.random.key(seed)
    ks = jax.random.split(key, 14)
    nrm = jax.random.normal
    f32 = jnp.float32
    return {
        "x": nrm(ks[0], (BATCH, SEQ, D_MODEL), f32),
        "ln_pre_g": 1.0 + 0.02 * nrm(ks[1], (DEPTH, D_MODEL), f32),
        "w_in": nrm(ks[2], (DEPTH, D_MODEL, PROJ_OUT), f32) * D_MODEL ** -0.5,
        "kv_norm_g": 1.0 + 0.02 * nrm(ks[3], (DEPTH, KV_RANK), f32),
        "w_uk": nrm(ks[4], (DEPTH, KV_RANK, MLA_HEADS * MLA_NOPE), f32) * KV_RANK ** -0.5,
        "w_uv": nrm(ks[5], (DEPTH, KV_RANK, MLA_HEADS * MLA_V), f32) * KV_RANK ** -0.5,
        "lambda_q1": 0.1 * nrm(ks[6], (DEPTH, DIFF_QK), f32),
        "lambda_k1": 0.1 * nrm(ks[7], (DEPTH, DIFF_QK), f32),
        "lambda_q2": 0.1 * nrm(ks[8], (DEPTH, DIFF_QK), f32),
        "lambda_k2": 0.1 * nrm(ks[9], (DEPTH, DIFF_QK), f32),
        "subln_g": 1.0 + 0.02 * nrm(ks[10], (DEPTH, DIFF_V), f32),
        "w_out": nrm(ks[11], (DEPTH, MIX_WIDTH, D_MODEL), f32) * MIX_WIDTH ** -0.5,
        "ln_post_g": 1.0 + 0.02 * nrm(ks[12], (DEPTH, D_MODEL), f32),
    }


def reference(x, ln_pre_g, w_in, kv_norm_g, w_uk, w_uv, lambda_q1, lambda_k1,
              lambda_q2, lambda_k2, subln_g, w_out, ln_post_g):
    B, S, _ = x.shape
    cos_a, sin_a = rope_tables(S, MLA_ROPE)
    cos_b, sin_b = rope_tables(S, DIFF_ROPE)
    mla_scale = 1.0 / math.sqrt(MLA_NOPE + MLA_ROPE)
    diff_scale = 1.0 / math.sqrt(DIFF_QK)

    for l in range(DEPTH):
        lambda_init = 0.8 - 0.6 * math.exp(-0.3 * l)
        h = rmsnorm(x, ln_pre_g[l])
        proj = h @ w_in[l]
        (q_nope, q_rope, c_kv, k_rope, g_a,
         dq, dk, dv, g_b) = jnp.split(proj, PROJ_SPLITS, axis=-1)

        q_nope = q_nope.reshape(B, S, MLA_HEADS, MLA_NOPE)
        q_rope = apply_rope(q_rope.reshape(B, S, MLA_HEADS, MLA_ROPE), cos_a, sin_a)
        c_kv = rmsnorm(c_kv, kv_norm_g[l])
        k_nope = (c_kv @ w_uk[l]).reshape(B, S, MLA_HEADS, MLA_NOPE)
        v_a = (c_kv @ w_uv[l]).reshape(B, S, MLA_HEADS, MLA_V)
        k_rope = apply_rope(k_rope[:, :, None, :], cos_a, sin_a)
        k_rope = jnp.broadcast_to(k_rope, (B, S, MLA_HEADS, MLA_ROPE))
        q_a = jnp.concatenate([q_nope, q_rope], axis=-1)
        k_a = jnp.concatenate([k_nope, k_rope], axis=-1)
        o_a = causal_attention(q_a, k_a, v_a, mla_scale).reshape(B, S, MLA_WIDTH)
        o_a = o_a * jax.nn.silu(g_a)

        dq = apply_rope(dq.reshape(B, S, DIFF_HEADS, 2, DIFF_QK), cos_b, sin_b)
        dk = apply_rope(dk.reshape(B, S, DIFF_HEADS, 2, DIFF_QK), cos_b, sin_b)
        dv = dv.reshape(B, S, DIFF_HEADS, DIFF_V)
        lam = (jnp.exp(jnp.sum(lambda_q1[l].astype(jnp.float32) * lambda_k1[l].astype(jnp.float32)))
               - jnp.exp(jnp.sum(lambda_q2[l].astype(jnp.float32) * lambda_k2[l].astype(jnp.float32)))
               + lambda_init)
        a1 = causal_attention(dq[..., 0, :], dk[..., 0, :], dv, diff_scale)
        a2 = causal_attention(dq[..., 1, :], dk[..., 1, :], dv, diff_scale)
        o_b = a1 - lam.astype(a1.dtype) * a2
        o_b = rmsnorm(o_b, subln_g[l], SUBLN_EPS) * (1.0 - lambda_init)
        o_b = o_b.reshape(B, S, DIFF_WIDTH) * jax.nn.silu(g_b)

        mixed = jnp.concatenate([o_a, o_b], axis=-1) @ w_out[l]
        x = x + rmsnorm(mixed, ln_post_g[l])
    return x
```

```cpp
#include <hip/hip_runtime.h>
#include <cstdio>
#include <cstdint>

#ifndef MK_N_LAUNCHES
#define MK_N_LAUNCHES 6
#endif
namespace pg8 {
#define PG8_LAS __attribute__((address_space(3)))
typedef unsigned short bf16_t;
typedef short bf16x8 __attribute__((ext_vector_type(8)));
typedef float f32x4 __attribute__((ext_vector_type(4)));
typedef unsigned u32x4 __attribute__((ext_vector_type(4)));
constexpr int BM = 256, BK = 64, HALF = 128, HTB = HALF * BK * 2  , STAGE_BYTES = 8 * HTB, NXCD = 8, WGM = 8;

__host__ __device__ __forceinline__ int lds_byte(int r, int c) { const int st = (r >> 4) * 2 + (c >> 5), rr = r & 15, cc = c & 31, ob = rr * 64 + cc * 2; return st * 1024 + (ob ^ (((ob >> 9) & 1) << 5)); }
__host__ __device__ __forceinline__ void stage_rc(int b, int& R, int& C) { const int st = b / 1024, sb = b % 1024, swz = sb ^ (((sb >> 9) & 1) << 5); R = (st >> 1) * 16 + swz / 64; C = (st & 1) * 32 + (swz % 64) / 2; }
__host__ __device__ __forceinline__ int perm32(int rho) { const int n = rho >> 4, i = rho & 15; return 8 * (i >> 2) + 4 * n + (i & 3); }

struct Unit { int pm, pn; };
struct Gemm { const bf16_t* A; const bf16_t* Bt; int M, N, K; };

struct StaticOrder {
    int nM, nN, nwg, G, c;
    __host__ __device__ void init(int M, int N, int G_, int c_) { nM = M / BM; nN = N / BM; nwg = nM * nN; G = G_; c = c_; }
    __host__ __device__ bool next(int i, Unit& u) const {
        const long L = (long)i * G + c; if (L >= nwg) return false;
        int wgid = (int)L; { const int q = nwg / NXCD, r = nwg % NXCD, xcd = wgid % NXCD, off = wgid / NXCD; wgid = (xcd < r ? xcd * (q + 1) : r * (q + 1) + (xcd - r) * q) + off; }
        const int nig = WGM * nN, gid = wgid / nig, fm = gid * WGM, gsz = (nM - fm) < WGM ? (nM - fm) : WGM;
        u.pm = fm + ((wgid % nig) % gsz); u.pn = (wgid % nig) / gsz; return true;
    }
    __device__ __forceinline__ void a_ready(const Unit&) const {}
    __device__ __forceinline__ void done(const Unit&) const {}
};
__device__ __forceinline__ unsigned cvt_pk_bf16(float lo, float hi) { unsigned r; asm volatile("v_cvt_pk_bf16_f32 %0, %1, %2" : "=v"(r) : "v"(lo), "v"(hi)); return r; }
typedef float f32x2 __attribute__((ext_vector_type(2)));
__device__ __forceinline__ void st8(bf16_t* p, const float* v) {
    u32x4 w; w.x = cvt_pk_bf16(v[0], v[1]); w.y = cvt_pk_bf16(v[2], v[3]); w.z = cvt_pk_bf16(v[4], v[5]); w.w = cvt_pk_bf16(v[6], v[7]); *(u32x4*)p = w;
}
__device__ __forceinline__ float silu_f(float g) { return g * __builtin_amdgcn_rcpf(1.0f + __builtin_amdgcn_exp2f(-1.4426950408889634f * g)); }

#define PJ_ROWS(...) _Pragma("unroll") for (int ai = 0; ai < 2; ++ai) _Pragma("unroll") for (int m = 0; m < 4; ++m) { \
    const int row = row0 + ai * HALF + m * 16; float v0[8], v1[8]; \
    _Pragma("unroll") for (int e = 0; e < 4; ++e) { v0[e] = acc[ai][0][m][0][e]; v0[4 + e] = acc[ai][0][m][1][e]; v1[e] = acc[ai][1][m][0][e]; v1[4 + e] = acc[ai][1][m][1][e]; } \
    __VA_ARGS__ }

struct EpiProj {
    static constexpr bool PERM = true, AFTER_DRAIN = false;
    bf16_t *QN, *QR, *CN, *KR, *GA, *DQ, *DKB, *DV, *GB; float* SS;
    const float *cosA, *sinA, *cosB, *sinB; float CA, CB;
    __device__ __forceinline__ void operator()(const f32x4 (&acc)[2][2][4][2], const Unit& u, int wr, int wc, int fr, int fq) const {
        const int pn = u.pn, row0 = u.pm * BM + wr * 64 + fr, c8 = wc * 32 + 8 * fq;
        if (pn < 2 || pn == 10 || pn == 11) {
            bf16_t* D = pn < 2 ? QN + pn * 256 : DV + (pn - 10) * 256; const float sc = pn < 2 ? CA : 1.0f;
            PJ_ROWS({ float o0[8], o1[8];
                _Pragma("unroll") for (int e = 0; e < 8; ++e) { o0[e] = v0[e] * sc; o1[e] = v1[e] * sc; }
                bf16_t* p = D + (size_t)row * 512 + c8; st8(p, o0); st8(p + HALF, o1); })
        } else if (pn == 4 || pn == 5 || pn >= 12) {
            bf16_t* D = pn < 12 ? GA + (pn - 4) * 256 : GB + (pn - 12) * 256;
            PJ_ROWS({ float o0[8], o1[8];
                _Pragma("unroll") for (int e = 0; e < 8; ++e) { o0[e] = silu_f(v0[e]); o1[e] = silu_f(v1[e]); }
                bf16_t* p = D + (size_t)row * 512 + c8; st8(p, o0); st8(p + HALF, o1); })
        } else if (pn == 2) {
            PJ_ROWS({ const int s = row & 2047; const float* cp = cosA + s * 32 + 8 * fq; const float* sp = sinA + s * 32 + 8 * fq;
                const f32x4 c0 = *(const f32x4*)cp, c1 = *(const f32x4*)(cp + 4), s0 = *(const f32x4*)sp, s1 = *(const f32x4*)(sp + 4);
                float o0[8], o1[8];
                _Pragma("unroll") for (int e = 0; e < 8; ++e) { const float c = e < 4 ? c0[e & 3] : c1[e & 3], sn = e < 4 ? s0[e & 3] : s1[e & 3];
                    o0[e] = (v0[e] * c - v1[e] * sn) * CA; o1[e] = (v1[e] * c + v0[e] * sn) * CA; }
                bf16_t* p = QR + (size_t)row * 256 + wc * 64 + 8 * fq; st8(p, o0); st8(p + 32, o1); })
        } else if (pn == 3) {
            if (wc < 2) {
                PJ_ROWS({ bf16_t* p = CN + (size_t)row * 128 + c8; st8(p, v0); st8(p + 64, v1);
                    float ss = 0.f;
                    _Pragma("unroll") for (int e = 0; e < 8; ++e) ss += v0[e] * v0[e] + v1[e] * v1[e];
                    ss += __shfl_xor(ss, 16); ss += __shfl_xor(ss, 32);
                    if (fq == 0) SS[(size_t)row * 2 + wc] = ss; })
            } else if (wc == 2) {
                PJ_ROWS({ const int s = row & 2047; const float* cp = cosA + s * 32 + 8 * fq; const float* sp = sinA + s * 32 + 8 * fq;
                    const f32x4 c0 = *(const f32x4*)cp, c1 = *(const f32x4*)(cp + 4), s0 = *(const f32x4*)sp, s1 = *(const f32x4*)(sp + 4);
                    float o0[8], o1[8];
                    _Pragma("unroll") for (int e = 0; e < 8; ++e) { const float c = e < 4 ? c0[e & 3] : c1[e & 3], sn = e < 4 ? s0[e & 3] : s1[e & 3];
                        o0[e] = v0[e] * c - v1[e] * sn; o1[e] = v1[e] * c + v0[e] * sn; }
                    bf16_t* p = KR + (size_t)row * 64 + 8 * fq; st8(p, o0); st8(p + 32, o1); })
            }
        } else {
            bf16_t* D = (pn < 8 ? DQ : DKB) + (pn & 1) * 256; const float sc = pn < 8 ? CB : 1.0f;
            const int d0b = fq == 0 ? 0 : 8 + 8 * fq, d1b = fq == 0 ? 8 : 32 + 8 * fq;
            PJ_ROWS({ const int s = row & 2047; const float* cp = cosB + s * 8; const float* sp = sinB + s * 8;
                const f32x4 c0 = *(const f32x4*)cp, c1 = *(const f32x4*)(cp + 4), s0 = *(const f32x4*)sp, s1 = *(const f32x4*)(sp + 4);
                float o0[8], o1[8];
                _Pragma("unroll") for (int e = 0; e < 8; ++e) { const float c = e < 4 ? c0[e & 3] : c1[e & 3], sn = e < 4 ? s0[e & 3] : s1[e & 3];
                    const float r0 = v0[e] * c - v1[e] * sn, r1 = v1[e] * c + v0[e] * sn;
                    o0[e] = (fq == 0 ? r0 : v0[e]) * sc; o1[e] = (fq == 0 ? r1 : v1[e]) * sc; }
                bf16_t* p = D + (size_t)row * 512 + wc * 64; st8(p + d0b, o0); st8(p + d1b, o1); })
        }
    }
};
struct EpiMix {
    static constexpr bool PERM = true, AFTER_DRAIN = false;
    bf16_t* Y; float* SS2;
    __device__ __forceinline__ void operator()(const f32x4 (&acc)[2][2][4][2], const Unit& u, int wr, int wc, int fr, int fq) const {
        const int row0 = u.pm * BM + wr * 64 + fr, c8 = u.pn * BM + wc * 32 + 8 * fq;
        PJ_ROWS({ bf16_t* p = Y + (size_t)row * 1024 + c8; st8(p, v0); st8(p + HALF, v1);
            float ss = 0.f;
            _Pragma("unroll") for (int e = 0; e < 8; ++e) ss += v0[e] * v0[e] + v1[e] * v1[e];
            ss += __shfl_xor(ss, 16); ss += __shfl_xor(ss, 32);
            if (fq == 0) SS2[(size_t)row * 16 + u.pn * 4 + wc] = ss; })
    }
};
#undef PJ_ROWS
template <class Epi, class Sched, bool ALIGN_EPI = false, bool SP2 = false>
__device__ __forceinline__ void gemm_phase(PG8_LAS unsigned char* lds, const Gemm g, const Sched& S, const Epi& E) {
    const int tid = threadIdx.x, wid = __builtin_amdgcn_readfirstlane(tid >> 6), lane = tid & 63, wr = wid >> 2, wc = wid & 3, fr = lane & 15, fq = lane >> 4;
    const int K = g.K, nt = K / BK;
    unsigned voffA[2], voffB[2];
#pragma unroll
    for (int i = 0; i < 2; ++i) { int R, C; stage_rc(tid * 16 + i * 8192, R, C); const int Rb = Epi::PERM ? ((R & ~31) + perm32(R & 31)) : R;
        voffA[i] = (unsigned)(R * K + C) * 2u; voffB[i] = (unsigned)(Rb * K + C) * 2u; }
    const size_t kstep = (size_t)(BK * 2);
    const size_t hstep = (size_t)HALF * K * 2;
    const size_t tstep = 2 * hstep;
    const unsigned ldsw = (unsigned)wid * 1024u;
    const int aoff = lds_byte(wr * 64 + fr, fq * 8), boff = lds_byte(wc * 32 + fr, fq * 8);
#define PG8_SA(b, h) (((b) * 2 + (h)) * HTB)
#define PG8_SB(b, h) ((4 + (b) * 2 + (h)) * HTB)
#define PG8_STAGE(bufoff, gbase, voff) do { _Pragma("unroll") for (int _i = 0; _i < 2; ++_i) \
        __builtin_amdgcn_global_load_lds((const unsigned*)((const char*)(gbase) + (voff)[_i]), (PG8_LAS unsigned*)(lds + (bufoff) + ldsw + _i * 8192), 16, 0, 0); } while (0)
#define PG8_LDA(dst, b, h) do { _Pragma("unroll") for (int m = 0; m < 4; ++m) _Pragma("unroll") for (int k = 0; k < 2; ++k) dst[m][k] = *(const PG8_LAS bf16x8*)(lds + PG8_SA(b, h) + aoff + m * 2048 + k * 1024); } while (0)
#define PG8_LDB(dst, b, h) do { _Pragma("unroll") for (int n = 0; n < 2; ++n) _Pragma("unroll") for (int k = 0; k < 2; ++k) dst[n][k] = *(const PG8_LAS bf16x8*)(lds + PG8_SB(b, h) + boff + n * 2048 + k * 1024); } while (0)
#define PG8_MMA(ai, bj, At, Bt) do { __builtin_amdgcn_s_setprio(1); _Pragma("unroll") for (int m = 0; m < 4; ++m) _Pragma("unroll") for (int n = 0; n < 2; ++n) _Pragma("unroll") for (int k = 0; k < 2; ++k) \
        acc[ai][bj][m][n] = __builtin_amdgcn_mfma_f32_16x16x32_bf16(Bt[n][k], At[m][k], acc[ai][bj][m][n], 0, 0, 0); __builtin_amdgcn_s_setprio(0); } while (0)
#define PG8_WAIT_V(n) asm volatile("s_waitcnt vmcnt(" #n ")" ::: "memory")
#define PG8_WAIT_L(n) asm volatile("s_waitcnt lgkmcnt(" #n ")" ::: "memory")
#define PG8_BAR __builtin_amdgcn_s_barrier()
#define PG8_SCHED __builtin_amdgcn_sched_barrier(0)
    Unit cur, nxt; int ui = 0;
    if (!S.next(0, cur)) return;
    f32x4 acc[2][2][4][2];
#pragma unroll
    for (int a = 0; a < 2; ++a)
#pragma unroll
        for (int b = 0; b < 2; ++b)
#pragma unroll
            for (int m = 0; m < 4; ++m)
#pragma unroll
                for (int n = 0; n < 2; ++n) acc[a][b][m][n] = (f32x4){0.f, 0.f, 0.f, 0.f};
    bf16x8 At[4][2], B0[2][2], B1[2][2];
    const char* cA = (const char*)g.A + (size_t)cur.pm * tstep; const char* cB = (const char*)g.Bt + (size_t)cur.pn * tstep;
    S.a_ready(cur);
    if constexpr (SP2) {
        PG8_STAGE(PG8_SB(0, 0), cB, voffB); PG8_STAGE(PG8_SB(0, 1), cB + hstep, voffB); PG8_STAGE(PG8_SA(0, 0), cA, voffA); PG8_STAGE(PG8_SA(0, 1), cA + hstep, voffA);
        if (wr == 1) PG8_BAR;
        PG8_WAIT_V(2); PG8_BAR;
        PG8_STAGE(PG8_SB(1, 0), cB + kstep, voffB); PG8_STAGE(PG8_SA(1, 0), cA + kstep, voffA); PG8_STAGE(PG8_SB(1, 1), cB + hstep + kstep, voffB);
        PG8_WAIT_V(6); PG8_BAR;
    } else {
        PG8_STAGE(PG8_SB(0, 0), cB, voffB); PG8_STAGE(PG8_SA(0, 0), cA, voffA); PG8_STAGE(PG8_SB(0, 1), cB + hstep, voffB); PG8_STAGE(PG8_SA(0, 1), cA + hstep, voffA);
        if (wr == 1) PG8_BAR;
        PG8_WAIT_V(4); PG8_BAR;
        PG8_STAGE(PG8_SB(1, 0), cB + kstep, voffB); PG8_STAGE(PG8_SA(1, 0), cA + kstep, voffA); PG8_STAGE(PG8_SB(1, 1), cB + hstep + kstep, voffB);
        PG8_WAIT_V(6); PG8_BAR;
    }
    for (;;) {
        const bool has_next = S.next(ui + 1, nxt);
        const char* nA = has_next ? (const char*)g.A + (size_t)nxt.pm * tstep : cA; const char* nB = has_next ? (const char*)g.Bt + (size_t)nxt.pn * tstep : cB;
        for (int t = 0; t < nt; t += 2) {
            const bool last = (t == nt - 2);
            const char* a1 = cA + (size_t)(t + 1) * kstep;
            const char* a2 = last ? nA : cA + (size_t)(t + 2) * kstep; const char* b2 = last ? nB : cB + (size_t)(t + 2) * kstep;
            const char* a3 = a2 + kstep; const char* b3 = b2 + kstep;
            if (last && has_next) S.a_ready(nxt);
            if constexpr (SP2) {
            PG8_LDB(B0, 0, 0); PG8_LDB(B1, 0, 1); PG8_SCHED; PG8_LDA(At, 0, 0); PG8_STAGE(PG8_SA(1, 1), a1 + hstep, voffA);
            PG8_WAIT_V(8); PG8_WAIT_L(0); PG8_BAR; PG8_MMA(0, 0, At, B0); PG8_MMA(0, 1, At, B1); PG8_BAR; PG8_SCHED;
            PG8_LDA(At, 0, 1); PG8_STAGE(PG8_SB(0, 0), b2, voffB); PG8_STAGE(PG8_SB(0, 1), b2 + hstep, voffB); PG8_STAGE(PG8_SA(0, 0), a2, voffA);
            PG8_WAIT_V(8); PG8_WAIT_L(0); PG8_BAR; PG8_MMA(1, 0, At, B0); PG8_MMA(1, 1, At, B1); PG8_BAR; PG8_SCHED;
            PG8_LDB(B0, 1, 0); PG8_LDB(B1, 1, 1); PG8_SCHED; PG8_LDA(At, 1, 0); PG8_STAGE(PG8_SA(0, 1), a2 + hstep, voffA);
            PG8_WAIT_V(8); PG8_WAIT_L(0); PG8_BAR; PG8_MMA(0, 0, At, B0); PG8_MMA(0, 1, At, B1); PG8_BAR; PG8_SCHED;
            PG8_LDA(At, 1, 1); PG8_STAGE(PG8_SB(1, 0), b3, voffB); PG8_STAGE(PG8_SB(1, 1), b3 + hstep, voffB); PG8_STAGE(PG8_SA(1, 0), a3, voffA);
            PG8_WAIT_V(8); PG8_WAIT_L(0); PG8_BAR; PG8_MMA(1, 0, At, B0); PG8_MMA(1, 1, At, B1); PG8_BAR; PG8_SCHED;
            } else {
            PG8_LDB(B0, 0, 0); PG8_SCHED; PG8_LDA(At, 0, 0); PG8_STAGE(PG8_SA(1, 1), a1 + hstep, voffA);
            PG8_WAIT_L(8); PG8_BAR; PG8_WAIT_L(0); PG8_MMA(0, 0, At, B0); PG8_BAR; PG8_SCHED;
            PG8_LDB(B1, 0, 1); PG8_STAGE(PG8_SB(0, 0), b2, voffB);
            PG8_BAR; PG8_WAIT_L(0); PG8_MMA(0, 1, At, B1); PG8_BAR;
            PG8_LDA(At, 0, 1); PG8_STAGE(PG8_SA(0, 0), a2, voffA);
            PG8_BAR; PG8_WAIT_L(0); PG8_MMA(1, 0, At, B0); PG8_BAR; PG8_SCHED;
            PG8_STAGE(PG8_SB(0, 1), b2 + hstep, voffB);
            PG8_WAIT_V(6); PG8_BAR; PG8_MMA(1, 1, At, B1); PG8_BAR;
            PG8_LDB(B0, 1, 0); PG8_SCHED; PG8_LDA(At, 1, 0); PG8_STAGE(PG8_SA(0, 1), a2 + hstep, voffA);
            PG8_WAIT_L(8); PG8_BAR; PG8_WAIT_L(0); PG8_MMA(0, 0, At, B0); PG8_BAR; PG8_SCHED;
            PG8_LDB(B1, 1, 1); PG8_STAGE(PG8_SB(1, 0), b3, voffB);
            PG8_BAR; PG8_WAIT_L(0); PG8_MMA(0, 1, At, B1); PG8_BAR;
            PG8_LDA(At, 1, 1); PG8_STAGE(PG8_SA(1, 0), a3, voffA);
            PG8_BAR; PG8_WAIT_L(0); PG8_MMA(1, 0, At, B0); PG8_BAR; PG8_SCHED;
            PG8_STAGE(PG8_SB(1, 1), b3 + hstep, voffB);
            PG8_WAIT_V(6); PG8_BAR; PG8_MMA(1, 1, At, B1); PG8_BAR;
            }
        }
        if constexpr (ALIGN_EPI) { if (wr == 0) PG8_BAR; }
        if constexpr (!Epi::AFTER_DRAIN) { E(acc, cur, wr, wc, fr, fq); S.done(cur); }
        if (!has_next) break;
#pragma unroll
        for (int a = 0; a < 2; ++a)
#pragma unroll
            for (int b = 0; b < 2; ++b)
#pragma unroll
                for (int m = 0; m < 4; ++m)
#pragma unroll
                    for (int n = 0; n < 2; ++n) acc[a][b][m][n] = (f32x4){0.f, 0.f, 0.f, 0.f};
        cur = nxt; cA = nA; cB = nB; ++ui;
        if constexpr (ALIGN_EPI) { if (wr == 1) PG8_BAR; }
    }
    PG8_WAIT_V(0);
    if constexpr (!ALIGN_EPI) { if (wr == 0) PG8_BAR; }
    PG8_BAR;
    if constexpr (Epi::AFTER_DRAIN) { E.fused(acc, cur, wr, wc, fr, fq, lds, wid, lane); S.done(cur); }
#undef PG8_SA
#undef PG8_SB
#undef PG8_STAGE
#undef PG8_LDA
#undef PG8_LDB
#undef PG8_MMA
#undef PG8_WAIT_V
#undef PG8_WAIT_L
#undef PG8_BAR
#undef PG8_SCHED
}
}
#define GAS __attribute__((address_space(1)))
#define LAS __attribute__((address_space(3)))
typedef unsigned short bf16;
typedef unsigned v4u __attribute__((ext_vector_type(4)));
typedef float f32x4 __attribute__((ext_vector_type(4)));
typedef short bf16x8 __attribute__((ext_vector_type(8)));
typedef GAS unsigned gu32;
typedef GAS unsigned long long gu64;
#define RLX_AGENT __ATOMIC_RELAXED, __HIP_MEMORY_SCOPE_AGENT
#define LDS_WAIT() asm volatile("s_waitcnt lgkmcnt(0)" ::: "memory")
#define VM_WAIT() asm volatile("s_waitcnt vmcnt(0)" ::: "memory")
__device__ __forceinline__ unsigned long long rt() { return __builtin_amdgcn_s_memrealtime(); }
__device__ __forceinline__ unsigned f2bf(float f) { unsigned u = __builtin_bit_cast(unsigned, f); return (u + 0x7fffu + ((u >> 16) & 1u)) >> 16; }
__device__ __forceinline__ unsigned pk2(float lo, float hi) { return f2bf(lo) | (f2bf(hi) << 16); }

#define XB_TMO      128
#define XB_XCNT(j)  (256  + 64 * (j))
#define XB_XSUB(j)  (1280 + 64 * (j))
#define XB_XGEN(j)  (2304 + 64 * (j))
#define XB_TOP      3328
#define XB_TOPGEN   3392
#define XCD_BAR_WORDS 3456
#define XB_SPIN_CAP (1u << 18)

__device__ __forceinline__ unsigned xb_ld(unsigned* p)              { return __hip_atomic_load(p, __ATOMIC_RELAXED, __HIP_MEMORY_SCOPE_AGENT); }
__device__ __forceinline__ unsigned xb_add(unsigned* p, unsigned v) { return __hip_atomic_fetch_add(p, v, __ATOMIC_RELAXED, __HIP_MEMORY_SCOPE_AGENT); }
__device__ __forceinline__ unsigned xb_xcc_id() { return (unsigned)__builtin_amdgcn_s_getreg((3 << 11) | 20) & 0xFu; }
#define XB_SPIN(cond, bar) do { unsigned _sp = 0; while (cond) { __builtin_amdgcn_s_sleep(1); \
    if ((++_sp & 255u) == 0u) { if (xb_ld(&(bar)[XB_TMO])) break; if (_sp > XB_SPIN_CAP) { atomicAdd(&(bar)[XB_TMO], 1u); break; } } } } while (0)

struct XcdBarrier {
    unsigned* bar; unsigned x;
    volatile LAS unsigned* st;
};

__device__ __forceinline__ XcdBarrier xcd_barrier_post(unsigned* bar, volatile LAS unsigned* st) {
    XcdBarrier b; b.bar = bar; b.x = xb_xcc_id(); b.st = st;
    if (threadIdx.x == 0) (void)xb_add(&bar[XB_XCNT(b.x)], 1u);
    return b;
}
__device__ __forceinline__ void xcd_barrier_complete(unsigned* bar, unsigned x, unsigned& nloc, unsigned& nx) {
    const unsigned G = gridDim.x * gridDim.y * gridDim.z;
    unsigned sum, cnt, mine, sp = 0u;
    for (;;) {
        sum = 0u; cnt = 0u; mine = 0u;
#pragma unroll
        for (unsigned j = 0; j < 16; ++j) { const unsigned c = xb_ld(&bar[XB_XCNT(j)]); sum += c; cnt += (c > 0u) ? 1u : 0u; mine = (j == x) ? c : mine; }
        if (sum == G) break;
        __builtin_amdgcn_s_sleep(1);
        if ((++sp & 255u) == 0u) { if (xb_ld(&bar[XB_TMO])) break; if (sp > XB_SPIN_CAP) { atomicAdd(&bar[XB_TMO], 1u); break; } }
    }
    nloc = mine > 0u ? mine : 1u; nx = cnt > 0u ? cnt : 1u;
}

__device__ __forceinline__ void xcd_barrier(const XcdBarrier& b) {
    asm volatile("s_waitcnt vmcnt(0)" ::: "memory");
    __syncthreads();
    if (threadIdx.x == 0) {
        unsigned* bar = b.bar;
        __builtin_amdgcn_s_waitcnt(0);
        unsigned nloc = b.st[0], nx = b.st[1];
        if (nloc == 0u) { xcd_barrier_complete(bar, b.x, nloc, nx); b.st[0] = nloc; b.st[1] = nx; }
        const unsigned old = xb_add(&bar[XB_XSUB(b.x)], 1u);
        const unsigned gen = old / nloc;
        if (old + 1u == (gen + 1u) * nloc) {
            __builtin_amdgcn_fence(__ATOMIC_RELEASE, "agent");
            asm volatile("s_waitcnt vmcnt(0)" ::: "memory");
            const unsigned og = xb_add(&bar[XB_TOP], 1u);
            const unsigned tg = og / nx;
            if (og + 1u == (tg + 1u) * nx) xb_add(&bar[XB_TOPGEN], 1u);
            else XB_SPIN(xb_ld(&bar[XB_TOPGEN]) == tg, bar);
            __builtin_amdgcn_fence(__ATOMIC_ACQUIRE, "agent");
            xb_add(&bar[XB_XGEN(b.x)], 1u);
            asm volatile("s_waitcnt vmcnt(0)" ::: "memory");
        } else {
            XB_SPIN(xb_ld(&bar[XB_XGEN(b.x)]) == gen, bar);
            __builtin_amdgcn_fence(__ATOMIC_ACQUIRE, "agent");
            asm volatile("s_waitcnt vmcnt(0)" ::: "memory");
        }
    }
    __syncthreads();
}
namespace att {
typedef unsigned short bf16_t;
typedef short bf16x8 __attribute__((ext_vector_type(8)));
typedef short s16x4 __attribute__((ext_vector_type(4)));
typedef float f32x16 __attribute__((ext_vector_type(16)));
typedef float f32x2_t __attribute__((ext_vector_type(2)));
typedef __bf16 bf16x2_t __attribute__((ext_vector_type(2)));
typedef unsigned u32x4 __attribute__((ext_vector_type(4)));
#define ALAS __attribute__((address_space(3)))
constexpr int L_K0 = 0, KBUF = 24576, L_V0 = 49152, VBUF = 16384, L_WS = 81920, L_END = 83968;
constexpr float THR = 8.0f;

__device__ __forceinline__ int crow(int r, int hi) { return (r & 3) + 8 * (r >> 2) + 4 * hi; }
__device__ __forceinline__ unsigned cvtpk(float lo, float hi) { f32x2_t v = {lo, hi}; bf16x2_t b = __builtin_convertvector(v, bf16x2_t); return __builtin_bit_cast(unsigned, b); }
__device__ __forceinline__ float bf_lo(unsigned w) { return __builtin_bit_cast(float, w << 16); }
__device__ __forceinline__ float bf_hi(unsigned w) { return __builtin_bit_cast(float, w & 0xffff0000u); }
__device__ __forceinline__ s16x4 vtr(const ALAS unsigned char* p) { return __builtin_bit_cast(s16x4, __builtin_amdgcn_ds_read_tr16_b64_v4i16((ALAS s16x4*)p)); }
__device__ __forceinline__ void glds(const void* g, ALAS unsigned char* l) { __builtin_amdgcn_global_load_lds((const unsigned*)g, (ALAS unsigned*)l, 16, 0, 0); }

struct PassArgs {
    const bf16_t* q0p; int qpitch0; const bf16_t* q1p; int qpitch1;
    const bf16_t* k0p; int kpitch0; const bf16_t* k1p; int kpitch1;
    const bf16_t* vp; int vpitch; int q0;
};

template <int DK>
__device__ __forceinline__ void attn_pass(const PassArgs& a, ALAS unsigned char* lds, f32x16 (&o)[4], float& l_out) {
    const int tid = threadIdx.x, lane = tid & 63, r32 = lane & 31, hi = lane >> 5;
    const int wid = __builtin_amdgcn_readfirstlane(tid >> 6);
    constexpr int NKS = DK / 16, NKP = DK / 64;
    bf16x8 qr[NKS];
    { const bf16_t* q0 = a.q0p + (size_t)(wid * 32 + r32) * a.qpitch0 + hi * 8;
#pragma unroll
      for (int d0 = 0; d0 < (NKS < 8 ? NKS : 8); ++d0) qr[d0] = *(const bf16x8*)(q0 + d0 * 16);
      if constexpr (DK == 192) { const bf16_t* q1 = a.q1p + (size_t)(wid * 32 + r32) * a.qpitch1 + hi * 8;
#pragma unroll
          for (int d0 = 8; d0 < 12; ++d0) qr[d0] = *(const bf16x8*)(q1 + (d0 - 8) * 16); } }
    const bf16_t* ks0; const bf16_t* ks1 = nullptr; const bf16_t* ks2 = nullptr;
    { const int row = 16 * (wid & 3) + (lane & 15), cq = lane >> 4;
      ks0 = a.k0p + (size_t)row * a.kpitch0 + (4 * (wid >> 2) + cq) * 8;
      if constexpr (DK == 192) { ks1 = a.k0p + (size_t)row * a.kpitch0 + (4 * (2 + (wid >> 2)) + cq) * 8; ks2 = a.k1p + (size_t)row * a.kpitch1 + (4 * (wid >> 2) + cq) * 8; } }
    const bf16_t* vs0 = a.vp + (size_t)(16 * (wid & 3) + (lane >> 2)) * a.vpitch + (wid >> 2) * 32 + (lane & 3) * 8;
    const bf16_t* vs1 = vs0 + 64;
    const size_t kst0 = (size_t)64 * a.kpitch0, kst1 = (size_t)64 * a.kpitch1, vst = (size_t)64 * a.vpitch;
    const int pw = wid * 1024;
#define ATT_DMA(t, b) do { ALAS unsigned char* kb_ = lds + L_K0 + (b) * KBUF + pw; ALAS unsigned char* vb_ = lds + L_V0 + (b) * VBUF + pw; \
        glds(ks0 + (size_t)(t) * kst0, kb_); \
        if constexpr (DK == 192) { glds(ks1 + (size_t)(t) * kst0, kb_ + 8192); glds(ks2 + (size_t)(t) * kst1, kb_ + 16384); } \
        glds(vs0 + (size_t)(t) * vst, vb_); glds(vs1 + (size_t)(t) * vst, vb_ + 8192); } while (0)
    const int NT = (a.q0 + 256) >> 6;
    const int qlo = a.q0 + wid * 32, qpos = qlo + r32;
    ALAS float* wsf = (ALAS float*)(lds + L_WS) + wid * 64;
    const int kb_lane = (r32 >> 4) * 1024 + hi * 256 + (r32 & 15) * 16;
    const int vb_lane = ((lane >> 4) & 1) * 32 + (lane & 3) * 8 + (4 * hi + ((lane & 15) >> 2)) * 64;
    float m_reg = -1e30f, l_reg = 0.f;
#pragma unroll
    for (int cb = 0; cb < 4; ++cb) o[cb] = f32x16{};
    ATT_DMA(0, 0);
    for (int t = 0; t < NT; ++t) {
        asm volatile("s_waitcnt vmcnt(0)" ::: "memory");
        __syncthreads();
        if (t + 1 < NT) ATT_DMA(t + 1, (t + 1) & 1);
        const ALAS unsigned char* kp = lds + L_K0 + (t & 1) * KBUF + kb_lane;
        const ALAS unsigned char* vp = lds + L_V0 + (t & 1) * VBUF + vb_lane;
        f32x16 p0 = f32x16{}, p1 = f32x16{};
#pragma unroll
        for (int d0 = 0; d0 < NKS; ++d0) {
            const bf16x8 b0 = *(const ALAS bf16x8*)(kp + (d0 >> 1) * 4096 + (d0 & 1) * 512);
            const bf16x8 b1 = *(const ALAS bf16x8*)(kp + (d0 >> 1) * 4096 + (d0 & 1) * 512 + 2048);
            p0 = __builtin_amdgcn_mfma_f32_32x32x16_bf16(b0, qr[d0], p0, 0, 0, 0);
            p1 = __builtin_amdgcn_mfma_f32_32x32x16_bf16(b1, qr[d0], p1, 0, 0, 0);
        }
        if (64 * t + 63 > qlo) {
            const float NEG = -__builtin_inff(); const int kb = 64 * t + 4 * hi;
#pragma unroll
            for (int r = 0; r < 16; ++r) { const int kv = kb + (r & 3) + 8 * (r >> 2); if (kv > qpos) p0[r] = NEG; if (kv + 32 > qpos) p1[r] = NEG; }
        }
        float pmax = p0[0];
#pragma unroll
        for (int r = 1; r < 16; ++r) pmax = fmaxf(pmax, p0[r]);
#pragma unroll
        for (int r = 0; r < 16; ++r) pmax = fmaxf(pmax, p1[r]);
        { auto rr = __builtin_amdgcn_permlane32_swap(__float_as_uint(pmax), __float_as_uint(pmax), false, false);
          pmax = fmaxf(__uint_as_float(rr[0]), __uint_as_float(rr[1])); }
        float alpha = 1.0f;
        if (!__all(pmax - m_reg <= THR)) { const float mn = fmaxf(m_reg, pmax); alpha = __builtin_amdgcn_exp2f(m_reg - mn); m_reg = mn; }
        float ps = 0.f;
#pragma unroll
        for (int r = 0; r < 16; ++r) { p0[r] = __builtin_amdgcn_exp2f(p0[r] - m_reg); p1[r] = __builtin_amdgcn_exp2f(p1[r] - m_reg); ps += p0[r] + p1[r]; }
        { auto rr = __builtin_amdgcn_permlane32_swap(__float_as_uint(ps), __float_as_uint(ps), false, false);
          ps = __uint_as_float(rr[0]) + __uint_as_float(rr[1]); }
        l_reg = l_reg * alpha + ps;
        if (__any(alpha < 1.0f)) {
            if (hi == 0) wsf[r32] = alpha;
#pragma unroll
            for (int r = 0; r < 16; ++r) { const float f = wsf[crow(r, hi)];
#pragma unroll
                for (int cb = 0; cb < 4; ++cb) o[cb][r] *= f; }
        }
        u32x4 w0 = {cvtpk(p0[0], p0[1]), cvtpk(p0[2], p0[3]), cvtpk(p0[4], p0[5]), cvtpk(p0[6], p0[7])};
        u32x4 w1 = {cvtpk(p0[8], p0[9]), cvtpk(p0[10], p0[11]), cvtpk(p0[12], p0[13]), cvtpk(p0[14], p0[15])};
        u32x4 w2 = {cvtpk(p1[0], p1[1]), cvtpk(p1[2], p1[3]), cvtpk(p1[4], p1[5]), cvtpk(p1[6], p1[7])};
        u32x4 w3 = {cvtpk(p1[8], p1[9]), cvtpk(p1[10], p1[11]), cvtpk(p1[12], p1[13]), cvtpk(p1[14], p1[15])};
        const bf16x8 pa0 = __builtin_bit_cast(bf16x8, w0), pa1 = __builtin_bit_cast(bf16x8, w1), pa2 = __builtin_bit_cast(bf16x8, w2), pa3 = __builtin_bit_cast(bf16x8, w3);
#pragma unroll
        for (int cb = 0; cb < 4; ++cb) {
            s16x4 lo[4], hh[4];
#pragma unroll
            for (int ks = 0; ks < 4; ++ks) { lo[ks] = vtr(vp + cb * 4096 + ks * 1024); hh[ks] = vtr(vp + cb * 4096 + ks * 1024 + 512); }
#define ATT_VF(k) (bf16x8){lo[k][0], lo[k][1], lo[k][2], lo[k][3], hh[k][0], hh[k][1], hh[k][2], hh[k][3]}
            o[cb] = __builtin_amdgcn_mfma_f32_32x32x16_bf16(pa0, ATT_VF(0), o[cb], 0, 0, 0);
            o[cb] = __builtin_amdgcn_mfma_f32_32x32x16_bf16(pa1, ATT_VF(1), o[cb], 0, 0, 0);
            o[cb] = __builtin_amdgcn_mfma_f32_32x32x16_bf16(pa2, ATT_VF(2), o[cb], 0, 0, 0);
            o[cb] = __builtin_amdgcn_mfma_f32_32x32x16_bf16(pa3, ATT_VF(3), o[cb], 0, 0, 0);
#undef ATT_VF
        }
    }
    __syncthreads();
    l_out = l_reg;
#undef ATT_DMA
}

__device__ __forceinline__ void row_recip(float l, ALAS float* wsf, int r32, int hi, float (&rl)[16]) {
    if (hi == 0) wsf[32 + r32] = l;
#pragma unroll
    for (int r = 0; r < 16; ++r) rl[r] = __builtin_amdgcn_rcpf(wsf[32 + crow(r, hi)]);
}
__device__ __forceinline__ void stage_tile(const f32x16 (&v)[4], ALAS bf16_t* stg, int r32, int hi) {
#pragma unroll
    for (int r = 0; r < 16; ++r) { const int orow = crow(r, hi);
#pragma unroll
        for (int cb = 0; cb < 4; ++cb) stg[orow * 128 + cb * 32 + r32] = (bf16_t)(cvtpk(v[cb][r], 0.f) & 0xffffu); }
}
template <bool SUBLN>
__device__ __forceinline__ void finish_tile(const ALAS bf16_t* stg, const bf16_t* gate  , int gpitch, bf16_t* out  , int opitch,
                                            const float* subg, int lane_) {
    int lane = lane_; asm volatile("" : "+v"(lane));
    const int ch = lane & 15;
    float g8[8];
    if constexpr (SUBLN) {
#pragma unroll
        for (int e = 0; e < 8; ++e) g8[e] = subg[ch * 8 + e] * 0.8f;
    }
#pragma unroll
    for (int i = 0; i < 8; ++i) {
        const int row = 4 * i + (lane >> 4);
        const u32x4 w = *(const ALAS u32x4*)(stg + row * 128 + ch * 8);
        const u32x4 gw = *(const u32x4*)(gate + (size_t)row * gpitch + ch * 8);
        float x[8] = {bf_lo(w.x), bf_hi(w.x), bf_lo(w.y), bf_hi(w.y), bf_lo(w.z), bf_hi(w.z), bf_lo(w.w), bf_hi(w.w)};
        const float g[8] = {bf_lo(gw.x), bf_hi(gw.x), bf_lo(gw.y), bf_hi(gw.y), bf_lo(gw.z), bf_hi(gw.z), bf_lo(gw.w), bf_hi(gw.w)};
        if constexpr (SUBLN) {
            float ss = 0.f;
#pragma unroll
            for (int e = 0; e < 8; ++e) ss += x[e] * x[e];
            ss += __shfl_xor(ss, 1); ss += __shfl_xor(ss, 2); ss += __shfl_xor(ss, 4); ss += __shfl_xor(ss, 8);
            const float rstd = __builtin_amdgcn_rsqf(ss * (1.0f / 128.0f) + 1e-5f);
#pragma unroll
            for (int e = 0; e < 8; ++e) x[e] = x[e] * rstd * g8[e];
        }
        u32x4 ow; ow.x = cvtpk(x[0] * g[0], x[1] * g[1]); ow.y = cvtpk(x[2] * g[2], x[3] * g[3]); ow.z = cvtpk(x[4] * g[4], x[5] * g[5]); ow.w = cvtpk(x[6] * g[6], x[7] * g[7]);
        *(u32x4*)(out + (size_t)row * opitch + ch * 8) = ow;
    }
}
}
namespace upj {
typedef unsigned short bf16_t;
typedef short bf16x8 __attribute__((ext_vector_type(8)));
typedef float f32x4 __attribute__((ext_vector_type(4)));
typedef unsigned u32x4 __attribute__((ext_vector_type(4)));
typedef unsigned u32x2 __attribute__((ext_vector_type(2)));
#define ULAS __attribute__((address_space(3)))
__device__ __forceinline__ void up_unit(ULAS unsigned char* lds, const bf16_t* CN, const bf16_t* Wt, const float* SS, bf16_t* KV, int pm, int pn) {
    const int tid = threadIdx.x, lane = tid & 63, fr = lane & 15, fq = lane >> 4;
    const int wid = __builtin_amdgcn_readfirstlane(tid >> 6), wr = wid >> 2, wc = wid & 3;
    ULAS unsigned char* As = lds; ULAS unsigned char* Bs = lds + 65536;
    { const u32x4* ga = (const u32x4*)(CN + (size_t)pm * 256 * 128); const u32x4* gb = (const u32x4*)(Wt + (size_t)pn * 256 * 128);
      u32x4 ra[8], rb[8];
#pragma unroll
      for (int i = 0; i < 8; ++i) { ra[i] = ga[tid + 512 * i]; rb[i] = gb[tid + 512 * i]; }
#pragma unroll
      for (int i = 0; i < 8; ++i) { const int idx = tid + 512 * i, row = idx >> 4, ch = idx & 15, off = row * 256 + ((ch ^ (row & 15)) << 4);
          *(ULAS u32x4*)(As + off) = ra[i]; *(ULAS u32x4*)(Bs + off) = rb[i]; } }
    __syncthreads();
    f32x4 acc[8][4];
#pragma unroll
    for (int mi = 0; mi < 8; ++mi)
#pragma unroll
        for (int ni = 0; ni < 4; ++ni) acc[mi][ni] = (f32x4){0.f, 0.f, 0.f, 0.f};
#pragma unroll
    for (int kk = 0; kk < 4; ++kk) {
        const int ch = kk * 4 + fq;
        bf16x8 af[8], bfr[4];
#pragma unroll
        for (int mi = 0; mi < 8; ++mi) { const int row = wr * 128 + mi * 16 + fr; af[mi] = *(const ULAS bf16x8*)(As + row * 256 + ((ch ^ (row & 15)) << 4)); }
#pragma unroll
        for (int ni = 0; ni < 4; ++ni) { const int row = wc * 64 + ni * 16 + fr; bfr[ni] = *(const ULAS bf16x8*)(Bs + row * 256 + ((ch ^ (row & 15)) << 4)); }
#pragma unroll
        for (int mi = 0; mi < 8; ++mi)
#pragma unroll
            for (int ni = 0; ni < 4; ++ni) acc[mi][ni] = __builtin_amdgcn_mfma_f32_16x16x32_bf16(bfr[ni], af[mi], acc[mi][ni], 0, 0, 0);
    }
#pragma unroll
    for (int mi = 0; mi < 8; ++mi) {
        const int row = pm * 256 + wr * 128 + mi * 16 + fr;
        const float r = __builtin_amdgcn_rsqf((SS[(size_t)row * 2] + SS[(size_t)row * 2 + 1]) * (1.0f / 128.0f) + 1e-6f);
#pragma unroll
        for (int ni = 0; ni < 4; ++ni) { const f32x4 v = acc[mi][ni] * r;
            u32x2 w; w.x = pg8::cvt_pk_bf16(v[0], v[1]); w.y = pg8::cvt_pk_bf16(v[2], v[3]);
            *(u32x2*)(KV + (size_t)row * 1024 + pn * 256 + wc * 64 + ni * 16 + 4 * fq) = w; }
    }
    __syncthreads();
}
}
constexpr int NWAVES = 8;
constexpr int N_LAUNCHES = MK_N_LAUNCHES;
constexpr int PER_PHASE = 6;
constexpr int BATCH = 8, SEQ = 2048, DMODEL = 1024, M = BATCH * SEQ;
constexpr int NPROJ = 3584;
constexpr size_t MiB = 1u << 20;
constexpr size_t WS_CTL = 0, CTL_ZERO_BYTES = 1 * MiB;
constexpr size_t WS_W1T = 2 * MiB;
constexpr size_t WS_WUP = 9 * MiB;
constexpr size_t WS_WOUT = 10 * MiB;
constexpr size_t WS_COSA = 12 * MiB, WS_SINA = WS_COSA + 256 * 1024, WS_COSB = WS_COSA + 512 * 1024, WS_SINB = WS_COSA + 576 * 1024;
constexpr size_t WS_SS = 13 * MiB;
constexpr size_t WS_SS2 = 14 * MiB;
constexpr size_t WS_XB = 16 * MiB;
constexpr size_t WS_Y = WS_XB;
constexpr size_t WS_QN = 48 * MiB;
constexpr size_t WS_QR = 64 * MiB;
constexpr size_t WS_CN = 72 * MiB;
constexpr size_t WS_KR = 76 * MiB;
constexpr size_t WS_GA = 80 * MiB;
constexpr size_t WS_DQ = 96 * MiB, WS_DK = 112 * MiB, WS_DV = 128 * MiB, WS_GB = 144 * MiB;
constexpr size_t WS_KV = 160 * MiB;
constexpr size_t WS_MIX = 192 * MiB;
constexpr size_t WS_END = 224 * MiB;
constexpr int CW_BAR = 4096;
constexpr int RING_OFF = 0, RING_BYTES = 131072;
constexpr int LDSCTL_OFF = RING_BYTES, MISC_OFF = LDSCTL_OFF + 320;
constexpr int LDS_BYTES = 147456;
static_assert(att::L_END <= RING_BYTES, "attention LDS");

__device__ __forceinline__ float wave_sum(float v) {
#pragma unroll
    for (int o = 1; o < 64; o <<= 1) v += __shfl_xor(v, o);
    return v;
}
__device__ __forceinline__ int colmap1(int np) {
    const int pn = np >> 8, j = np & 255, bj = j >> 7, jj = j & 127;
    if (pn < 2) return np;
    if (pn == 2) return 512 + (jj >> 5) * 64 + 32 * bj + (jj & 31);
    if (pn == 3) return jj < 64 ? 768 + bj * 64 + jj : (jj < 96 ? 896 + 32 * bj + (jj - 64) : -1);
    if (pn < 6) return 960 + (np - 1024);
    if (pn < 10) { const int base = pn < 8 ? 1472 + (pn - 6) * 256 : 1984 + (pn - 8) * 256, g = jj >> 5, e = jj & 31;
        const int dim = bj == 0 ? (e < 8 ? e : 8 + e) : (e < 8 ? 8 + e : 32 + e); return base + g * 64 + dim; }
    if (pn < 12) return 2496 + (np - 2560);
    return 3008 + (np - 3072);
}
template <int MODE>
__device__ __forceinline__ void p0_item(const float* W, const float* W2, const float* gk, int K, bf16* WT, int nblk, LAS float* scr, int item, int lane) {
    const int kb = item / nblk, nb = item % nblk, k0 = 64 * kb, n0 = 32 * nb, np = n0 + (lane & 31);
    const float* src; int pitch; bool ok = true;
    if constexpr (MODE == 0) { const int c = colmap1(np); ok = c >= 0; src = W + (ok ? c : 0); pitch = 3520; }
    else if constexpr (MODE == 1) { src = np < 512 ? W + np : W2 + (np - 512); pitch = 512; }
    else { src = W + np; pitch = 1024; }
#pragma unroll 8
    for (int i = 0; i < 32; ++i) { const int kk = 2 * i + (lane >> 5); float v = ok ? src[(size_t)(k0 + kk) * pitch] : 0.f; if constexpr (MODE != 2) v *= gk[k0 + kk]; scr[kk * 33 + (lane & 31)] = v; }
    LDS_WAIT(); asm volatile("" ::: "memory");
    const int c = lane & 7;
#pragma unroll
    for (int j = 0; j < 4; ++j) { const int n = (lane >> 3) + 8 * j; const LAS float* s = scr + (8 * c) * 33 + n;
        v4u o; o.x = pk2(s[0 * 33], s[1 * 33]); o.y = pk2(s[2 * 33], s[3 * 33]); o.z = pk2(s[4 * 33], s[5 * 33]); o.w = pk2(s[6 * 33], s[7 * 33]);
        *(GAS v4u*)(WT + (size_t)(n0 + n) * K + k0 + 8 * c) = o; }
    LDS_WAIT(); asm volatile("" ::: "memory");
}
__device__ __forceinline__ void rms_row_to_bf16(const float* xrow, bf16* orow, int lane) {
    const GAS f32x4* xr = (const GAS f32x4*)xrow + lane;
    f32x4 v[4]; float s = 0.f;
#pragma unroll
    for (int j = 0; j < 4; ++j) { v[j] = xr[64 * j]; s += (v[j].x * v[j].x + v[j].y * v[j].y) + (v[j].z * v[j].z + v[j].w * v[j].w); }
    const float r = 1.0f / sqrtf(wave_sum(s) * (1.0f / DMODEL) + 1e-6f);
    GAS unsigned long long* o8 = (GAS unsigned long long*)orow + lane;
#pragma unroll
    for (int j = 0; j < 4; ++j) o8[64 * j] = (unsigned long long)pk2(v[j].x * r, v[j].y * r) | ((unsigned long long)pk2(v[j].z * r, v[j].w * r) << 32);
}
__device__ __forceinline__ void rope_entry(int s, double ex, float& c, float& sn) {
    const double z = -ex * 18.931568569324174;
    const double zi = __builtin_rint(z), zf = (z - zi) * 0.6931471805599453;
    double p = 1.0;
#pragma unroll
    for (int i = 14; i >= 1; --i) p = 1.0 + p * zf * (1.0 / (double)i);
    const float inv_f = (float)__builtin_ldexp(p, (int)zi);
    const float ang = (float)s * inv_f;
    const double a = (double)ang, k = __builtin_rint(a * 0.6366197723675814);
    double y = __builtin_fma(-k, 1.5707963267948966, a); y = __builtin_fma(-k, 6.123233995736766e-17, y);
    const int q = (int)k & 3; const double y2 = y * y;
    const double sy = y * (1.0 + y2 * (-1.0 / 6 + y2 * (1.0 / 120 + y2 * (-1.0 / 5040 + y2 * (1.0 / 362880 + y2 * (-1.0 / 39916800 + y2 * (1.0 / 6227020800.0)))))));
    const double cy = 1.0 + y2 * (-0.5 + y2 * (1.0 / 24 + y2 * (-1.0 / 720 + y2 * (1.0 / 40320 + y2 * (-1.0 / 3628800 + y2 * (1.0 / 479001600 + y2 * (-1.0 / 87178291200.0)))))));
    const double cc = (q == 0) ? cy : (q == 1) ? -sy : (q == 2) ? -cy : sy;
    const double ss = (q == 0) ? sy : (q == 1) ? cy : (q == 2) ? -sy : -cy;
    c = (float)cc; sn = (float)ss;
}

struct Args { const float* in[13]; float* out; unsigned char* ws; int ph_lo, ph_hi, li, pad; };
__global__ void __launch_bounds__(NWAVES * 64, 2) hymba_fwd(Args args) {
    extern __shared__ __attribute__((aligned(16))) unsigned char lds_raw[];
    LAS unsigned char* lds = (LAS unsigned char*)lds_raw;
    volatile LAS unsigned* MISC = (volatile LAS unsigned*)(lds + MISC_OFF);
    const int tid = threadIdx.x, lane = tid & 63, wave = __builtin_amdgcn_readfirstlane(tid >> 6);
    const int G = gridDim.x; const int bx = blockIdx.x; const int vcu = (G % 8 == 0) ? (bx % 8) * (G / 8) + bx / 8 : bx;
    unsigned char* ws = args.ws;
    gu32* ctl = (gu32*)(ws + WS_CTL);
    const float* x = args.in[0]; const float* ln_pre_g = args.in[1]; const float* w_in = args.in[2]; const float* kv_norm_g = args.in[3];
    const float* w_uk = args.in[4]; const float* w_uv = args.in[5]; const float* lq1 = args.in[6]; const float* lk1 = args.in[7];
    const float* lq2 = args.in[8]; const float* lk2 = args.in[9]; const float* subln_g = args.in[10]; const float* w_out = args.in[11]; const float* ln_post_g = args.in[12];
    float* out = args.out;
    bf16* W1T = (bf16*)(ws + WS_W1T); bf16* WUP = (bf16*)(ws + WS_WUP); bf16* WOUT = (bf16*)(ws + WS_WOUT);
    float* cosA = (float*)(ws + WS_COSA); float* sinA = (float*)(ws + WS_SINA); float* cosB = (float*)(ws + WS_COSB); float* sinB = (float*)(ws + WS_SINB);
    float* SS = (float*)(ws + WS_SS); float* SS2 = (float*)(ws + WS_SS2);
    bf16* XB = (bf16*)(ws + WS_XB); bf16* Y = (bf16*)(ws + WS_Y);
    bf16* QN = (bf16*)(ws + WS_QN); bf16* QR = (bf16*)(ws + WS_QR); bf16* CN = (bf16*)(ws + WS_CN); bf16* KR = (bf16*)(ws + WS_KR); bf16* GA = (bf16*)(ws + WS_GA);
    bf16* DQ = (bf16*)(ws + WS_DQ); bf16* DKB = (bf16*)(ws + WS_DK); bf16* DV = (bf16*)(ws + WS_DV); bf16* GB = (bf16*)(ws + WS_GB);
    bf16* KV = (bf16*)(ws + WS_KV); bf16* MIX = (bf16*)(ws + WS_MIX);

    for (int u = tid; u < (LDS_BYTES - LDSCTL_OFF) / 4; u += NWAVES * 64) ((LAS unsigned*)(lds + LDSCTL_OFF))[u] = 0u;
    __syncthreads();
    XcdBarrier bar; bar.bar = (unsigned*)(ctl + CW_BAR); bar.x = 0; bar.st = nullptr;
    if (N_LAUNCHES != PER_PHASE) bar = xcd_barrier_post((unsigned*)(ctl + CW_BAR), MISC + 8);
#define GRID_BAR() do { if (N_LAUNCHES != PER_PHASE) xcd_barrier(bar); } while (0)
    const int lo = args.ph_lo, hi = args.ph_hi;
#ifndef PHMASK
#define PHMASK 63
#endif
#define IN(k) ((((PHMASK) >> (k)) & 1) && lo <= (k) && (k) < hi)
#define BOTH(k) (IN(k) && IN((k) + 1))

    if (IN(0)) {
        LAS float* scr = (LAS float*)(lds + RING_OFF + wave * 16384);
        const int gw = vcu * NWAVES + wave, NGW = G * NWAVES;
        constexpr int I_1 = (DMODEL / 64) * (NPROJ / 32), I_U = (128 / 64) * (1024 / 32), I_O = (DMODEL / 64) * (DMODEL / 32);
        for (int it = gw; it < I_1 + I_U + I_O; it += NGW) {
            int r = it;
            if (r < I_1) { p0_item<0>(w_in, nullptr, ln_pre_g, DMODEL, W1T, NPROJ / 32, scr, r, lane); continue; } r -= I_1;
            if (r < I_U) { p0_item<1>(w_uk, w_uv, kv_norm_g, 128, WUP, 1024 / 32, scr, r, lane); continue; } r -= I_U;
            p0_item<2>(w_out, nullptr, nullptr, DMODEL, WOUT, DMODEL / 32, scr, r, lane);
        }
        for (int m = gw; m < M; m += NGW) rms_row_to_bf16(x + (size_t)m * DMODEL, XB + (size_t)m * DMODEL, lane);
        for (int e = bx * (NWAVES * 64) + tid; e < SEQ * 40; e += G * NWAVES * 64) {
            float c, sn;
            if (e < SEQ * 32) { const int s = e >> 5, f = e & 31; rope_entry(s, (double)f * (1.0 / 32.0), c, sn); cosA[e] = c; sinA[e] = sn; }
            else { const int e2 = e - SEQ * 32, s = e2 >> 3, f = e2 & 7; rope_entry(s, (double)f * (1.0 / 8.0), c, sn); cosB[e2] = c; sinB[e2] = sn; }
        }
        if (BOTH(0)) GRID_BAR();
    }
    if (IN(1)) {
        pg8::Gemm g{XB, W1T, M, NPROJ, DMODEL}; pg8::StaticOrder S; S.init(M, NPROJ, G, bx);
        pg8::EpiProj E{QN, QR, CN, KR, GA, DQ, DKB, DV, GB, SS, cosA, sinA, cosB, sinB, 0.07216878364870323f * 1.4426950408889634f, 0.125f * 1.4426950408889634f};
        pg8::gemm_phase<pg8::EpiProj, pg8::StaticOrder, true, true>(lds + RING_OFF, g, S, E);
        if (BOTH(1)) GRID_BAR();
    }
    if (IN(2)) {
        for (int u = vcu; u < 256; u += G) upj::up_unit(lds + RING_OFF, CN, WUP, SS, KV, u >> 2, u & 3);
        if (BOTH(2)) GRID_BAR();
    }
    if (IN(3)) {
        float lam;
        { const float p1 = lq1[lane] * lk1[lane], p2 = lq2[lane] * lk2[lane];
          lam = __builtin_amdgcn_exp2f(wave_sum(p1) * 1.4426950408889634f) - __builtin_amdgcn_exp2f(wave_sum(p2) * 1.4426950408889634f) + 0.2f; }
        const int r32 = lane & 31, hi5 = lane >> 5;
        LAS float* wsf = (LAS float*)(lds + RING_OFF + att::L_WS) + wave * 64;
        LAS bf16* stg = (LAS bf16*)(lds + RING_OFF + wave * 8192);
        for (int u = vcu; u < 256; u += G) {
            const int bh = u >> 3, b = bh >> 2, h = bh & 3, qa = u & 7, qbB = 7 - qa;
            const size_t rb = (size_t)b * SEQ;
#ifndef ATT_MASK
#define ATT_MASK 3
#endif
            if (ATT_MASK & 1) {
                const size_t rq = rb + (size_t)qa * 256;
                att::PassArgs pa{QN + rq * 512 + h * 128, 512, QR + rq * 256 + h * 64, 256, KV + rb * 1024 + h * 128, 1024, KR + rb * 64, 64, KV + rb * 1024 + 512 + h * 128, 1024, qa * 256};
                att::f32x16 o[4]; float l;
                att::attn_pass<192>(pa, lds + RING_OFF, o, l);
                float rl[16]; att::row_recip(l, wsf, r32, hi5, rl);
#pragma unroll
                for (int cb = 0; cb < 4; ++cb)
#pragma unroll
                    for (int r = 0; r < 16; ++r) o[cb][r] *= rl[r];
                att::stage_tile(o, stg, r32, hi5);
                const size_t rw = rq + (size_t)wave * 32;
                att::finish_tile<false>(stg, GA + rw * 512 + h * 128, 512, MIX + rw * 1024 + h * 128, 1024, nullptr, lane);
                __syncthreads();
            }
            if (ATT_MASK & 2) {
                const size_t rq = rb + (size_t)qbB * 256;
                unsigned a1p[2][16];
                {
                    att::PassArgs pb{DQ + rq * 512 + h * 128, 512, nullptr, 0, DKB + rb * 512 + h * 128, 512, nullptr, 0, DV + rb * 512 + h * 128, 512, qbB * 256};
                    att::f32x16 o[4]; float l; att::attn_pass<64>(pb, lds + RING_OFF, o, l);
                    float rl[16]; att::row_recip(l, wsf, r32, hi5, rl);
#pragma unroll
                    for (int r = 0; r < 16; ++r) { a1p[0][r] = att::cvtpk(o[0][r] * rl[r], o[1][r] * rl[r]); a1p[1][r] = att::cvtpk(o[2][r] * rl[r], o[3][r] * rl[r]); }
                }
                att::f32x16 a1[4];
                {
                    att::PassArgs pb{DQ + rq * 512 + h * 128 + 64, 512, nullptr, 0, DKB + rb * 512 + h * 128 + 64, 512, nullptr, 0, DV + rb * 512 + h * 128, 512, qbB * 256};
                    float l; att::attn_pass<64>(pb, lds + RING_OFF, a1, l);
                    float rl[16]; att::row_recip(l, wsf, r32, hi5, rl);
#pragma unroll
                    for (int r = 0; r < 16; ++r) { const float f = lam * rl[r];
                        a1[0][r] = att::bf_lo(a1p[0][r]) - f * a1[0][r]; a1[1][r] = att::bf_hi(a1p[0][r]) - f * a1[1][r];
                        a1[2][r] = att::bf_lo(a1p[1][r]) - f * a1[2][r]; a1[3][r] = att::bf_hi(a1p[1][r]) - f * a1[3][r]; }
                }
                att::stage_tile(a1, stg, r32, hi5);
                const size_t rw = rq + (size_t)wave * 32;
                att::finish_tile<true>(stg, GB + rw * 512 + h * 128, 512, MIX + rw * 1024 + 512 + h * 128, 1024, subln_g, lane);
                __syncthreads();
            }
        }
        if (BOTH(3)) GRID_BAR();
    }
    if (IN(4)) {
        pg8::Gemm g{MIX, WOUT, M, DMODEL, DMODEL}; pg8::StaticOrder S; S.init(M, DMODEL, G, bx);
        pg8::EpiMix E{Y, SS2};
        pg8::gemm_phase<pg8::EpiMix, pg8::StaticOrder, true, true>(lds + RING_OFF, g, S, E);
        if (BOTH(4)) GRID_BAR();
    }
    if (IN(5)) {
        const int gw = vcu * NWAVES + wave, NGW = G * NWAVES;
        f32x4 gp[4];
#pragma unroll
        for (int j = 0; j < 4; ++j) gp[j] = ((const f32x4*)ln_post_g)[lane + 64 * j];
        for (int m = gw; m < M; m += NGW) {
            float ss = SS2[(size_t)m * 16 + (lane & 15)];
            ss += __shfl_xor(ss, 1); ss += __shfl_xor(ss, 2); ss += __shfl_xor(ss, 4); ss += __shfl_xor(ss, 8);
            const float r = 1.0f / sqrtf(ss * (1.0f / DMODEL) + 1e-6f);
            const f32x4* xr = (const f32x4*)(x + (size_t)m * DMODEL) + lane; f32x4* orow = (f32x4*)(out + (size_t)m * DMODEL) + lane;
            const unsigned long long* yr = (const unsigned long long*)(Y + (size_t)m * DMODEL) + lane;
#pragma unroll
            for (int j = 0; j < 4; ++j) { const unsigned long long w = yr[64 * j]; const unsigned wl = (unsigned)w, wh = (unsigned)(w >> 32);
                f32x4 yv = {att::bf_lo(wl), att::bf_hi(wl), att::bf_lo(wh), att::bf_hi(wh)};
                orow[64 * j] = xr[64 * j] + yv * r * gp[j]; }
        }
    }
#undef IN
#undef BOTH
#undef GRID_BAR
}

extern "C" void kernel_launch(void* const* d_in, const int* in_sizes, int n_in, void* d_out, int out_size, void* d_ws, size_t ws_size, hipStream_t stream) {
    static int grid = 0;
    if (grid == 0) {
        if (n_in != 13 || in_sizes[0] != M * DMODEL || out_size != M * DMODEL || ws_size < WS_END) { fprintf(stderr, "kernel_launch: unexpected shapes (n_in %d, in0 %d, out %d, ws %zu)\n", n_in, n_in > 0 ? in_sizes[0] : -1, out_size, ws_size); grid = -1; return; }
        int dev = 0, cus = 0, per_cu = 0;
        if (hipGetDevice(&dev) != hipSuccess || hipDeviceGetAttribute(&cus, hipDeviceAttributeMultiprocessorCount, dev) != hipSuccess) { fprintf(stderr, "kernel_launch: device query failed\n"); grid = -1; return; }
        if (hipFuncSetAttribute((const void*)hymba_fwd, hipFuncAttributeMaxDynamicSharedMemorySize, LDS_BYTES) != hipSuccess) { fprintf(stderr, "kernel_launch: hipFuncSetAttribute failed\n"); grid = -1; return; }
        if (hipOccupancyMaxActiveBlocksPerMultiprocessor(&per_cu, (const void*)hymba_fwd, NWAVES * 64, LDS_BYTES) != hipSuccess || per_cu < 1)
            fprintf(stderr, "kernel_launch: note: occupancy query reports %d workgroups per CU\n", per_cu);
        (void)hipGetLastError();
        grid = cus;
    }
    if (grid < 0) return;
    if (hipMemsetAsync((char*)d_ws + WS_CTL, 0, CTL_ZERO_BYTES, stream) != hipSuccess) { fprintf(stderr, "kernel_launch: hipMemsetAsync failed\n"); return; }
    Args a{};
    for (int i = 0; i < 13; ++i) a.in[i] = (const float*)d_in[i];
    a.out = (float*)d_out; a.ws = (unsigned char*)d_ws;
    for (int li = 0; li < N_LAUNCHES; ++li) {
        a.ph_lo = (N_LAUNCHES == PER_PHASE) ? li : 0; a.ph_hi = (N_LAUNCHES == PER_PHASE) ? li + 1 : PER_PHASE; a.li = li;
        hipLaunchKernelGGL(hymba_fwd, dim3(grid), dim3(NWAVES * 64), LDS_BYTES, stream, a);
        const hipError_t le = hipPeekAtLastError();
        if (le != hipSuccess) { fprintf(stderr, "kernel_launch: launch %d failed: %s\n", li, hipGetErrorName(le)); break; }
    }
}
```
